# Optimizing an MI355X kernel written in HIP

```python
import math
import jax, jax.numpy as jnp
from jax import lax
import numpy as np

D_MODEL = 1024
BATCH = 8
SEQ = 4096
DEPTH = 2

N_MIXERS = 2
SSM_GROUP = 16
SSM_GROUPS = D_MODEL // SSM_GROUP
SSM_STATE = 64
DT_MIN = 1e-3
DT_MAX = 1e-1
SSM_C_STD = 0.5
SB_HEADS = 16
SB_HEAD_DIM = D_MODEL // SB_HEADS
Q_BLOCK = 128
FFN_HIDDEN = -(-8 * D_MODEL // (3 * 256)) * 256
DEEPNORM_ALPHA = (2 * DEPTH) ** 0.25
DEEPNORM_BETA = (8 * DEPTH) ** -0.25
LN_EPS = 1e-5
N_SSM_LAYERS = (DEPTH + 1) // 2
N_SB_LAYERS = DEPTH // 2

kernel_name = "interleaved_s5_stickbreaking_deepnorm"


def layer_norm(x, g, b):
    xf = x.astype(jnp.float32)
    mu = jnp.mean(xf, axis=-1, keepdims=True)
    var = jnp.mean(jnp.square(xf - mu), axis=-1, keepdims=True)
    y = (xf - mu) * lax.rsqrt(var + LN_EPS) * g.astype(jnp.float32) + b.astype(jnp.float32)
    return y.astype(x.dtype)


def _cmul(ar, ai, br, bi):
    return ar * br - ai * bi, ar * bi + ai * br


def _ssm_combine(left, right):
    alr, ali, blr, bli = left
    arr, ari, brr, bri = right
    ar, ai = _cmul(arr, ari, alr, ali)
    br, bi = _cmul(arr, ari, blr, bli)
    return ar, ai, br + brr, bi + bri


def s5_mixer(x, a_re, a_im, log_dt, b_re, b_im, c_re, c_im, d_skip, w_glu, w_out):
    bsz, seq, _ = x.shape
    f32 = jnp.float32
    u = x.astype(f32).reshape(bsz, seq, SSM_GROUPS, SSM_GROUP)
    dt = jnp.exp(log_dt.astype(f32))[:, None]
    lam_re = jnp.minimum(a_re.astype(f32), -1e-4)
    lam_im = a_im.astype(f32)
    mag = jnp.exp(lam_re * dt)
    lbar_re = mag * jnp.cos(lam_im * dt)
    lbar_im = mag * jnp.sin(lam_im * dt)
    den = lam_re * lam_re + lam_im * lam_im
    num_re = lbar_re - 1.0
    num_im = lbar_im
    coef_re = (num_re * lam_re + num_im * lam_im) / den
    coef_im = (num_im * lam_re - num_re * lam_im) / den
    bb_re, bb_im = _cmul(coef_re[..., None], coef_im[..., None],
                         b_re.astype(f32), b_im.astype(f32))
    bu_re = jnp.einsum('blgh,gph->lbgp', u, bb_re)
    bu_im = jnp.einsum('blgh,gph->lbgp', u, bb_im)
    a_seq_re = jnp.broadcast_to(lbar_re, (seq, 1, SSM_GROUPS, SSM_STATE))
    a_seq_im = jnp.broadcast_to(lbar_im, (seq, 1, SSM_GROUPS, SSM_STATE))
    _, _, s_re, s_im = lax.associative_scan(
        _ssm_combine, (a_seq_re, a_seq_im, bu_re, bu_im), axis=0)
    y = (jnp.einsum('lbgp,ghp->blgh', s_re, c_re.astype(f32))
         - jnp.einsum('lbgp,ghp->blgh', s_im, c_im.astype(f32)))
    y = y.reshape(bsz, seq, D_MODEL) + d_skip.astype(f32) * x.astype(f32)
    h = jax.nn.gelu(y).astype(x.dtype)
    val, gate = jnp.split(h @ w_glu, 2, axis=-1)
    z = val * jax.nn.sigmoid(gate)
    return (z @ w_out).astype(x.dtype)


def stick_breaking_mixer(x, w_qkv, w_o):
    bsz, seq, _ = x.shape
    f32 = jnp.float32
    q, k, v = jnp.split(x @ w_qkv, 3, axis=-1)
    to_heads = lambda t: t.reshape(bsz, seq, SB_HEADS, SB_HEAD_DIM).transpose(0, 2, 1, 3)
    q, k, v = to_heads(q), to_heads(k), to_heads(v)
    scale = SB_HEAD_DIM ** -0.5
    outs = []
    for blk in range(seq // Q_BLOCK):
        q0 = blk * Q_BLOCK
        kv_len = q0 + Q_BLOCK
        qb = q[:, :, q0:kv_len].astype(f32)
        kb = k[:, :, :kv_len].astype(f32)
        vb = v[:, :, :kv_len]
        z = jnp.einsum('bhqd,bhkd->bhqk', qb, kb) * scale
        t_idx = q0 + jnp.arange(Q_BLOCK)[:, None]
        s_idx = jnp.arange(kv_len)[None, :]
        past = s_idx < t_idx
        log_beta = jax.nn.log_sigmoid(z)
        log_1m_beta = jnp.where(past, jax.nn.log_sigmoid(-z), 0.0)
        between = lax.cumsum(log_1m_beta, axis=3, reverse=True) - log_1m_beta
        weights = jnp.where(past, jnp.exp(log_beta + between), 0.0)
        outs.append(jnp.einsum('bhqk,bhkd->bhqd', weights.astype(vb.dtype), vb))
    o = jnp.concatenate(outs, axis=2)
    o = o.transpose(0, 2, 1, 3).reshape(bsz, seq, D_MODEL)
    return (o @ w_o).astype(x.dtype)


def swiglu_ffn(x, w_gu, w_down):
    g, u = jnp.split(x @ w_gu, 2, axis=-1)
    return (jax.nn.silu(g) * u) @ w_down


def setup_inputs(seed: int = 0) -> dict:
    key = jax.random.key(seed)
    ks = jax.random.split(key, 24)
    f32 = jnp.float32
    nrm = lambda k, shape, std: jax.random.normal(k, shape, f32) * std
    G, P, H, D, F = SSM_GROUPS, SSM_STATE, SSM_GROUP, D_MODEL, FFN_HIDDEN
    x = jax.random.normal(ks[0], (BATCH, SEQ, D), f32)
    ssm_a_re = -0.5 + nrm(ks[1], (N_SSM_LAYERS, G, P), 0.01)
    ssm_a_im = (math.pi * jnp.arange(P, dtype=f32))[None, None, :] + nrm(ks[2], (N_SSM_LAYERS, G, P), 0.01)
    ssm_log_dt = jax.random.uniform(ks[3], (N_SSM_LAYERS, G), f32,
                                    minval=math.log(DT_MIN), maxval=math.log(DT_MAX))
    ssm_b_re = nrm(ks[4], (N_SSM_LAYERS, G, P, H), (2 * H) ** -0.5)
    ssm_b_im = nrm(ks[5], (N_SSM_LAYERS, G, P, H), (2 * H) ** -0.5)
    ssm_c_re = nrm(ks[6], (N_SSM_LAYERS, G, H, P), SSM_C_STD)
    ssm_c_im = nrm(ks[7], (N_SSM_LAYERS, G, H, P), SSM_C_STD)
    ssm_d = nrm(ks[8], (N_SSM_LAYERS, D), 1.0)
    ssm_w_glu = nrm(ks[9], (N_SSM_LAYERS, D, 2 * D), D ** -0.5)
    ssm_w_out = nrm(ks[10], (N_SSM_LAYERS, D, D), D ** -0.5 * DEEPNORM_BETA)
    sb_w_qkv = nrm(ks[11], (N_SB_LAYERS, D, 3 * D), D ** -0.5)
    sb_w_o = nrm(ks[12], (N_SB_LAYERS, D, D), D ** -0.5 * DEEPNORM_BETA)
    ffn_w_gu = nrm(ks[13], (DEPTH, D, 2 * F), D ** -0.5)
    ffn_w_down = nrm(ks[14], (DEPTH, F, D), F ** -0.5 * DEEPNORM_BETA)
    ln_mix_g = 1.0 + nrm(ks[15], (DEPTH, D), 0.02)
    ln_mix_b = nrm(ks[16], (DEPTH, D), 0.02)
    ln_ffn_g = 1.0 + nrm(ks[17], (DEPTH, D), 0.02)
    ln_ffn_b = nrm(ks[18], (DEPTH, D), 0.02)
    return {"x": x,
            "ssm_a_re": ssm_a_re, "ssm_a_im": ssm_a_im, "ssm_log_dt": ssm_log_dt,
            "ssm_b_re": ssm_b_re, "ssm_b_im": ssm_b_im,
            "ssm_c_re": ssm_c_re, "ssm_c_im": ssm_c_im, "ssm_d": ssm_d,
            "ssm_w_glu": ssm_w_glu, "ssm_w_out": ssm_w_out,
            "sb_w_qkv": sb_w_qkv, "sb_w_o": sb_w_o,
            "ffn_w_gu": ffn_w_gu, "ffn_w_down": ffn_w_down,
            "ln_mix_g": ln_mix_g, "ln_mix_b": ln_mix_b,
            "ln_ffn_g": ln_ffn_g, "ln_ffn_b": ln_ffn_b}


def reference(x, ssm_a_re, ssm_a_im, ssm_log_dt, ssm_b_re, ssm_b_im, ssm_c_re, ssm_c_im,
              ssm_d, ssm_w_glu, ssm_w_out, sb_w_qkv, sb_w_o, ffn_w_gu, ffn_w_down,
              ln_mix_g, ln_mix_b, ln_ffn_g, ln_ffn_b):
    h = x
    for i in range(DEPTH):
        j = i // N_MIXERS
        if i % N_MIXERS == 0:
            mix = s5_mixer(h, ssm_a_re[j], ssm_a_im[j], ssm_log_dt[j], ssm_b_re[j], ssm_b_im[j],
                           ssm_c_re[j], ssm_c_im[j], ssm_d[j], ssm_w_glu[j], ssm_w_out[j])
        else:
            mix = stick_breaking_mixer(h, sb_w_qkv[j], sb_w_o[j])
        h = layer_norm(DEEPNORM_ALPHA * h + mix, ln_mix_g[i], ln_mix_b[i])
        h = layer_norm(DEEPNORM_ALPHA * h + swiglu_ffn(h, ffn_w_gu[i], ffn_w_down[i]),
                       ln_ffn_g[i], ln_ffn_b[i])
    return h
```

```cpp
#include <hip/hip_runtime.h>
#include <hip/hip_cooperative_groups.h>
#include <cstdio>
#include <cstdint>
namespace cg = cooperative_groups;

#define LAS __attribute__((address_space(3)))
typedef unsigned short bf16_t;
typedef short bf16x8 __attribute__((ext_vector_type(8)));
typedef short s16x4 __attribute__((ext_vector_type(4)));
typedef float f32x4 __attribute__((ext_vector_type(4)));
typedef float f32x2 __attribute__((ext_vector_type(2)));
typedef float f32x16 __attribute__((ext_vector_type(16)));
typedef unsigned u32x4 __attribute__((ext_vector_type(4)));
typedef unsigned u32x2 __attribute__((ext_vector_type(2)));

constexpr int NB = 8, SEQ = 4096, D = 1024, M = NB * SEQ, NG = 64, NP = 64, GH = 16, FF = 2816, NHEAD = 16, HD = 64;
constexpr int CH = 64, NCH = SEQ / CH, GROWS = NB * NCH  , KA = 128 + CH * GH  ;
constexpr float LN_EPS = 1e-5f;
constexpr float ALPHA = 1.41421356237309515f;
constexpr float LOG2E = 1.4426950408889634f;
constexpr float QSCALE = 0.125f * LOG2E;
constexpr float DONE_THR = 152.0f;

constexpr size_t MiB = 1u << 20;
constexpr size_t WS_WGLU = 2 * MiB, WS_WOUT = 6 * MiB, WS_WQKV = 8 * MiB, WS_WO = 14 * MiB, WS_WGU0 = 16 * MiB, WS_WGU1 = 27 * MiB, WS_WDN0 = 38 * MiB, WS_WDN1 = 44 * MiB;
constexpr size_t WS_APOW = 50 * MiB, WS_BBAR = 53 * MiB, WS_KC = 54 * MiB;
constexpr size_t WS_XG = 64 * MiB, WS_BSSM = 136 * MiB, WS_BST = 280 * MiB, WS_SLOC = 312 * MiB, WS_HB = 328 * MiB, WS_Z = 392 * MiB;
constexpr size_t WS_HF = 64 * MiB, WS_HBF = 192 * MiB, WS_HID = 256 * MiB, WS_Q = 256 * MiB, WS_K = 320 * MiB, WS_VT = 384 * MiB, WS_OB = 448 * MiB, WS_END = 512 * MiB;

constexpr int LDS_BYTES = 147456;

__device__ __forceinline__ unsigned f2bf(float f) { unsigned u = __builtin_bit_cast(unsigned, f); return (u + 0x7fffu + ((u >> 16) & 1u)) >> 16; }
__device__ __forceinline__ unsigned pk2(float lo, float hi) { return f2bf(lo) | (f2bf(hi) << 16); }
__device__ __forceinline__ unsigned cvt_pk_bf16(float lo, float hi) { unsigned r; asm volatile("v_cvt_pk_bf16_f32 %0, %1, %2" : "=v"(r) : "v"(lo), "v"(hi)); return r; }
__device__ __forceinline__ float sigm(float x) { return __builtin_amdgcn_rcpf(1.0f + __builtin_amdgcn_exp2f(-x * LOG2E)); }
__device__ __forceinline__ float gelu_tanh(float y) { const float u = 0.7978845608028654f * (y + 0.044715f * y * y * y); return y * sigm(2.0f * u); }
__device__ __forceinline__ float wave_sum(float v) {
#pragma unroll
    for (int o = 1; o < 64; o <<= 1) v += __shfl_xor(v, o);
    return v;
}
__device__ __forceinline__ void dsincos(double x, double& s, double& c) {
    const double k = rint(x * 0.63661977236758134308);
    double r = fma(-k, 1.57079632679489655800e+00, x);
    r = fma(-k, 6.12323399573676603587e-17, r);
    const long long q = (long long)k;
    const double r2 = r * r;
    double ps = -1.0 / 1307674368000.0;
    ps = ps * r2 + 1.0 / 6227020800.0; ps = ps * r2 - 1.0 / 39916800.0; ps = ps * r2 + 1.0 / 362880.0; ps = ps * r2 - 1.0 / 5040.0; ps = ps * r2 + 1.0 / 120.0; ps = ps * r2 - 1.0 / 6.0;
    const double sr = r + r * r2 * ps;
    double pc = 1.0 / 20922789888000.0;
    pc = pc * r2 - 1.0 / 87178291200.0; pc = pc * r2 + 1.0 / 479001600.0; pc = pc * r2 - 1.0 / 3628800.0; pc = pc * r2 + 1.0 / 40320.0; pc = pc * r2 - 1.0 / 720.0; pc = pc * r2 + 1.0 / 24.0; pc = pc * r2 - 0.5;
    const double cr = 1.0 + r2 * pc;
    const int qq = (int)(q & 3);
    s = (qq == 0) ? sr : (qq == 1) ? cr : (qq == 2) ? -sr : -cr;
    c = (qq == 0) ? cr : (qq == 1) ? -sr : (qq == 2) ? -cr : sr;
}

namespace pg8 {
constexpr int BM = 256, BK = 64, HALF = 128, HTB = HALF * BK * 2, STAGE_BYTES = 8 * HTB, NXCD = 8, WGM = 8;
__host__ __device__ __forceinline__ int lds_byte(int r, int c) { const int st = (r >> 4) * 2 + (c >> 5), rr = r & 15, cc = c & 31, ob = rr * 64 + cc * 2; return st * 1024 + (ob ^ (((ob >> 9) & 1) << 5)); }
__host__ __device__ __forceinline__ void stage_rc(int b, int& R, int& C) { const int st = b / 1024, sb = b % 1024, swz = sb ^ (((sb >> 9) & 1) << 5); R = (st >> 1) * 16 + swz / 64; C = (st & 1) * 32 + (swz % 64) / 2; }
__host__ __device__ __forceinline__ int perm32(int rho) { const int n = rho >> 4, i = rho & 15; return 8 * (i >> 2) + 4 * n + (i & 3); }

struct Unit { int pm, pn; };
struct Gemm { const bf16_t* A; const bf16_t* Bt; int lda, ldb, K; };

struct StaticOrder {
    int nM, nN, nwg, G, c;
    __device__ void init(int M_, int N_, int G_, int c_) { nM = M_ / BM; nN = N_ / BM; nwg = nM * nN; G = G_; c = c_; }
    __device__ bool next(int i, Unit& u) const {
        const long Lx = (long)i * G + c; if (Lx >= nwg) return false;
        int wgid = (int)Lx; { const int q = nwg / NXCD, r = nwg % NXCD, xcd = wgid % NXCD, off = wgid / NXCD; wgid = (xcd < r ? xcd * (q + 1) : r * (q + 1) + (xcd - r) * q) + off; }
        const int nig = WGM * nN, gid = wgid / nig, fm = gid * WGM, gsz = (nM - fm) < WGM ? (nM - fm) : WGM;
        u.pm = fm + ((wgid % nig) % gsz); u.pn = (wgid % nig) / gsz; return true;
    }
};
struct GroupOrderY { int G, c; __device__ bool next(int i, Unit& u) const { const int Lx = i * G + c; if (Lx >= NG * 8) return false; const int g = Lx >> 3, r = Lx & 7; u.pm = 2 * g + (r >> 2); u.pn = 4 * g + (r & 3); return true; } };
struct GroupOrderS { int G, c; __device__ bool next(int i, Unit& u) const { const int Lx = i * G + c; if (Lx >= NG * 2) return false; const int g = Lx >> 1; u.pm = 2 * g + (Lx & 1); u.pn = g; return true; } };

typedef f32x4 Acc[2][2][4][2];

template <int MODE> struct EpiPair {
    static constexpr bool PERM = true;
    bf16_t* O; int ldc;
    __device__ __forceinline__ void operator()(const Acc& acc, const Unit& u, int wr, int wc, int fr, int fq) const {
        const int row0 = u.pm * BM + wr * 64 + fr, col0 = u.pn * HALF + wc * 32 + 8 * fq;
#pragma unroll
        for (int ai = 0; ai < 2; ++ai)
#pragma unroll
            for (int m = 0; m < 4; ++m) {
                bf16_t* rowp = O + (size_t)(row0 + ai * HALF + m * 16) * ldc + col0;
                float o[8];
#pragma unroll
                for (int n = 0; n < 2; ++n)
#pragma unroll
                    for (int e = 0; e < 4; ++e) { const float a = acc[ai][0][m][n][e], b = acc[ai][1][m][n][e]; o[n * 4 + e] = (MODE == 0) ? a * sigm(b) : a * sigm(a) * b; }
                u32x4 w; w.x = cvt_pk_bf16(o[0], o[1]); w.y = cvt_pk_bf16(o[2], o[3]); w.z = cvt_pk_bf16(o[4], o[5]); w.w = cvt_pk_bf16(o[6], o[7]);
                *(u32x4*)rowp = w;
                asm volatile("" ::: "memory");
            }
    }
};
struct EpiBf16 {
    static constexpr bool PERM = true;
    bf16_t* O; int ldc; int nsc; float scale0;
    __device__ __forceinline__ void operator()(const Acc& acc, const Unit& u, int wr, int wc, int fr, int fq) const {
        const int row0 = u.pm * BM + wr * 64 + fr, col0 = u.pn * BM + wc * 32 + 8 * fq;
        const float sc = (u.pn < nsc) ? scale0 : 1.f;
#pragma unroll
        for (int ai = 0; ai < 2; ++ai)
#pragma unroll
            for (int m = 0; m < 4; ++m) { bf16_t* rowp = O + (size_t)(row0 + ai * HALF + m * 16) * ldc + col0;
#pragma unroll
                for (int bj = 0; bj < 2; ++bj) { const f32x4 v0 = acc[ai][bj][m][0] * sc, v1 = acc[ai][bj][m][1] * sc;
                    u32x4 w; w.x = cvt_pk_bf16(v0[0], v0[1]); w.y = cvt_pk_bf16(v0[2], v0[3]); w.z = cvt_pk_bf16(v1[0], v1[1]); w.w = cvt_pk_bf16(v1[2], v1[3]);
                    *(u32x4*)(rowp + bj * HALF) = w; }
                asm volatile("" ::: "memory"); }
    }
};
struct EpiRes {
    static constexpr bool PERM = false;
    const float* base; float* out; float alpha;
    __device__ __forceinline__ void operator()(const Acc& acc, const Unit& u, int wr, int wc, int fr, int fq) const {
        const int row0 = u.pm * BM + wr * 64 + fr, col0 = u.pn * BM + wc * 32 + 4 * fq;
#pragma unroll
        for (int ai = 0; ai < 2; ++ai)
#pragma unroll
            for (int m = 0; m < 4; ++m) { const size_t off = (size_t)(row0 + ai * HALF + m * 16) * D + col0;
#pragma unroll
                for (int bj = 0; bj < 2; ++bj)
#pragma unroll
                    for (int n = 0; n < 2; ++n) { const f32x4 bs = *(const f32x4*)(base + off + bj * HALF + n * 16); *(f32x4*)(out + off + bj * HALF + n * 16) = bs * alpha + acc[ai][bj][m][n]; } }
    }
};
struct EpiState {
    static constexpr bool PERM = false;
    float* S;
    __device__ __forceinline__ void operator()(const Acc& acc, const Unit& u, int wr, int wc, int fr, int fq) const {
        const int row0 = u.pm * BM + wr * 64 + fr, col0 = wc * 32 + 4 * fq;
#pragma unroll
        for (int ai = 0; ai < 2; ++ai)
#pragma unroll
            for (int m = 0; m < 4; ++m) { float* rp = S + (size_t)(row0 + ai * HALF + m * 16) * 128 + col0;
#pragma unroll
                for (int n = 0; n < 2; ++n) *(f32x4*)(rp + n * 16) = acc[ai][0][m][n]; }
    }
};
struct EpiY {
    static constexpr bool PERM = true;
    const float* x; const float* dskip; bf16_t* O;
    __device__ __forceinline__ void operator()(const Acc& acc, const Unit& u, int wr, int wc, int fr, int fq) const {
        const int g = u.pn >> 2, pni = u.pn & 3;
        const int R0 = (u.pm & 1) * BM + wr * 64 + fr;
        const int ch0 = 16 * g + 8 * (fq & 1);
        f32x4 d0 = *(const f32x4*)(dskip + ch0), d1 = *(const f32x4*)(dskip + ch0 + 4);
#pragma unroll
        for (int ai = 0; ai < 2; ++ai)
#pragma unroll
            for (int m = 0; m < 4; ++m) { const int Rr = R0 + ai * HALF + m * 16;
#pragma unroll
                for (int bj = 0; bj < 2; ++bj) { const int i = 16 * pni + 8 * bj + 2 * wc + (fq >> 1); const size_t off = ((size_t)Rr * CH + i) * D + ch0;
                    const f32x4 x0 = *(const f32x4*)(x + off), x1 = *(const f32x4*)(x + off + 4);
                    f32x4 y0 = acc[ai][bj][m][0] + d0 * x0, y1 = acc[ai][bj][m][1] + d1 * x1;
                    u32x4 w; w.x = cvt_pk_bf16(gelu_tanh(y0[0]), gelu_tanh(y0[1])); w.y = cvt_pk_bf16(gelu_tanh(y0[2]), gelu_tanh(y0[3]));
                    w.z = cvt_pk_bf16(gelu_tanh(y1[0]), gelu_tanh(y1[1])); w.w = cvt_pk_bf16(gelu_tanh(y1[2]), gelu_tanh(y1[3]));
                    *(u32x4*)(O + off) = w; } }
    }
};

template <class Epi, class Sched, bool ALIGN_EPI>
__device__ __forceinline__ void gemm_phase(LAS unsigned char* lds, const Gemm g, const Sched& S, const Epi& E) {
    int tid = threadIdx.x; asm volatile("" : "+v"(tid));
    const int wid = __builtin_amdgcn_readfirstlane(tid >> 6), lane = tid & 63, wr = wid >> 2, wc = wid & 3, fr = lane & 15, fq = lane >> 4;
    const int K = g.K, nt = K / BK;
    unsigned voffA[2], voffB[2];
#pragma unroll
    for (int i = 0; i < 2; ++i) { int R, C; stage_rc(tid * 16 + i * 8192, R, C); const int Rb = Epi::PERM ? ((R & ~31) + perm32(R & 31)) : R;
        voffA[i] = (unsigned)(R * g.lda + C) * 2u; voffB[i] = (unsigned)(Rb * g.ldb + C) * 2u; }
    const size_t kstep = (size_t)(BK * 2);
    const size_t hsA = (size_t)HALF * g.lda * 2, hsB = (size_t)HALF * g.ldb * 2, tsA = 2 * hsA, tsB = 2 * hsB;
    const unsigned ldsw = (unsigned)wid * 1024u;
    const int aoff = lds_byte(wr * 64 + fr, fq * 8), boff = lds_byte(wc * 32 + fr, fq * 8);
#define PG8_SA(b, h) (((b) * 2 + (h)) * HTB)
#define PG8_SB(b, h) ((4 + (b) * 2 + (h)) * HTB)
#define PG8_STAGE(bufoff, gbase, voff) do { _Pragma("unroll") for (int _i = 0; _i < 2; ++_i) \
        __builtin_amdgcn_global_load_lds((const unsigned*)((const char*)(gbase) + (voff)[_i]), (LAS unsigned*)(lds + (bufoff) + ldsw + _i * 8192), 16, 0, 0); } while (0)
#define PG8_LDA(dst, b, h) do { _Pragma("unroll") for (int m = 0; m < 4; ++m) _Pragma("unroll") for (int k = 0; k < 2; ++k) dst[m][k] = *(const LAS bf16x8*)(lds + PG8_SA(b, h) + aoff + m * 2048 + k * 1024); } while (0)
#define PG8_LDB(dst, b, h) do { _Pragma("unroll") for (int n = 0; n < 2; ++n) _Pragma("unroll") for (int k = 0; k < 2; ++k) dst[n][k] = *(const LAS bf16x8*)(lds + PG8_SB(b, h) + boff + n * 2048 + k * 1024); } while (0)
#define PG8_MMA(ai, bj, At, Bt) do { __builtin_amdgcn_s_setprio(1); _Pragma("unroll") for (int m = 0; m < 4; ++m) _Pragma("unroll") for (int n = 0; n < 2; ++n) _Pragma("unroll") for (int k = 0; k < 2; ++k) \
        acc[ai][bj][m][n] = __builtin_amdgcn_mfma_f32_16x16x32_bf16(Bt[n][k], At[m][k], acc[ai][bj][m][n], 0, 0, 0); __builtin_amdgcn_s_setprio(0); } while (0)
#define PG8_WAIT_V(n) asm volatile("s_waitcnt vmcnt(" #n ")" ::: "memory")
#define PG8_WAIT_L(n) asm volatile("s_waitcnt lgkmcnt(" #n ")" ::: "memory")
#define PG8_BAR __builtin_amdgcn_s_barrier()
#define PG8_SCHED __builtin_amdgcn_sched_barrier(0)
    Unit cur, nxt; int ui = 0;
    if (!S.next(0, cur)) return;
    Acc acc;
#pragma unroll
    for (int a = 0; a < 2; ++a)
#pragma unroll
        for (int b = 0; b < 2; ++b)
#pragma unroll
            for (int m = 0; m < 4; ++m)
#pragma unroll
                for (int n = 0; n < 2; ++n) acc[a][b][m][n] = (f32x4){0.f, 0.f, 0.f, 0.f};
    bf16x8 At[4][2], B0[2][2], B1[2][2];
    const char* cA = (const char*)g.A + (size_t)cur.pm * tsA; const char* cB = (const char*)g.Bt + (size_t)cur.pn * tsB;
    PG8_STAGE(PG8_SB(0, 0), cB, voffB); PG8_STAGE(PG8_SB(0, 1), cB + hsB, voffB); PG8_STAGE(PG8_SA(0, 0), cA, voffA); PG8_STAGE(PG8_SA(0, 1), cA + hsA, voffA);
    if (wr == 1) PG8_BAR;
    PG8_WAIT_V(2); PG8_BAR;
    PG8_STAGE(PG8_SB(1, 0), cB + kstep, voffB); PG8_STAGE(PG8_SA(1, 0), cA + kstep, voffA); PG8_STAGE(PG8_SB(1, 1), cB + hsB + kstep, voffB);
    PG8_WAIT_V(6); PG8_BAR;
    for (;;) {
        const bool has_next = S.next(ui + 1, nxt);
        const char* nA = has_next ? (const char*)g.A + (size_t)nxt.pm * tsA : cA; const char* nB = has_next ? (const char*)g.Bt + (size_t)nxt.pn * tsB : cB;
        for (int t = 0; t < nt; t += 2) {
            const bool last = (t == nt - 2);
            const char* a1 = cA + (size_t)(t + 1) * kstep;
            const char* a2 = last ? nA : cA + (size_t)(t + 2) * kstep; const char* b2 = last ? nB : cB + (size_t)(t + 2) * kstep;
            const char* a3 = a2 + kstep; const char* b3 = b2 + kstep;
            PG8_LDB(B0, 0, 0); PG8_LDB(B1, 0, 1); PG8_SCHED; PG8_LDA(At, 0, 0); PG8_STAGE(PG8_SA(1, 1), a1 + hsA, voffA);
            PG8_WAIT_V(8); PG8_WAIT_L(0); PG8_BAR; PG8_MMA(0, 0, At, B0); PG8_MMA(0, 1, At, B1); PG8_BAR; PG8_SCHED;
            PG8_LDA(At, 0, 1); PG8_STAGE(PG8_SB(0, 0), b2, voffB); PG8_STAGE(PG8_SB(0, 1), b2 + hsB, voffB); PG8_STAGE(PG8_SA(0, 0), a2, voffA);
            PG8_WAIT_V(8); PG8_WAIT_L(0); PG8_BAR; PG8_MMA(1, 0, At, B0); PG8_MMA(1, 1, At, B1); PG8_BAR; PG8_SCHED;
            PG8_LDB(B0, 1, 0); PG8_LDB(B1, 1, 1); PG8_SCHED; PG8_LDA(At, 1, 0); PG8_STAGE(PG8_SA(0, 1), a2 + hsA, voffA);
            PG8_WAIT_V(8); PG8_WAIT_L(0); PG8_BAR; PG8_MMA(0, 0, At, B0); PG8_MMA(0, 1, At, B1); PG8_BAR; PG8_SCHED;
            PG8_LDA(At, 1, 1); PG8_STAGE(PG8_SB(1, 0), b3, voffB); PG8_STAGE(PG8_SB(1, 1), b3 + hsB, voffB); PG8_STAGE(PG8_SA(1, 0), a3, voffA);
            PG8_WAIT_V(8); PG8_WAIT_L(0); PG8_BAR; PG8_MMA(1, 0, At, B0); PG8_MMA(1, 1, At, B1); PG8_BAR; PG8_SCHED;
        }
        if constexpr (ALIGN_EPI) { if (wr == 0) PG8_BAR; }
        E(acc, cur, wr, wc, fr, fq);
        if (!has_next) break;
#pragma unroll
        for (int a = 0; a < 2; ++a)
#pragma unroll
            for (int b = 0; b < 2; ++b)
#pragma unroll
                for (int m = 0; m < 4; ++m)
#pragma unroll
                    for (int n = 0; n < 2; ++n) acc[a][b][m][n] = (f32x4){0.f, 0.f, 0.f, 0.f};
        cur = nxt; cA = nA; cB = nB; ++ui;
        if constexpr (ALIGN_EPI) { if (wr == 1) PG8_BAR; }
    }
    PG8_WAIT_V(0);
    if constexpr (!ALIGN_EPI) { if (wr == 0) PG8_BAR; }
    PG8_BAR;
#undef PG8_SA
#undef PG8_SB
#undef PG8_STAGE
#undef PG8_LDA
#undef PG8_LDB
#undef PG8_MMA
#undef PG8_WAIT_V
#undef PG8_WAIT_L
#undef PG8_BAR
#undef PG8_SCHED
}
}

__device__ __forceinline__ void transpose_item(const float* W, int K, int N, bf16_t* WT, int k0, int n0, int drow0, LAS float* scr, int lane) {
#pragma unroll 8
    for (int i = 0; i < 32; ++i) { const int kk = 2 * i + (lane >> 5); scr[kk * 33 + (lane & 31)] = W[(size_t)(k0 + kk) * N + n0 + (lane & 31)]; }
    asm volatile("s_waitcnt lgkmcnt(0)" ::: "memory");
    const int c = lane & 7;
#pragma unroll
    for (int j = 0; j < 4; ++j) { const int n = (lane >> 3) + 8 * j; const LAS float* s = scr + (8 * c) * 33 + n;
        u32x4 o; o.x = pk2(s[0 * 33], s[1 * 33]); o.y = pk2(s[2 * 33], s[3 * 33]); o.z = pk2(s[4 * 33], s[5 * 33]); o.w = pk2(s[6 * 33], s[7 * 33]);
        *(u32x4*)(WT + (size_t)(drow0 + n) * K + k0 + 8 * c) = o; }
    asm volatile("s_waitcnt lgkmcnt(0)" ::: "memory");
}
__device__ __forceinline__ int paired_row(int n0, int Nh) { return (n0 < Nh) ? (n0 >> 7) * 256 + (n0 & 127) : ((n0 - Nh) >> 7) * 256 + 128 + ((n0 - Nh) & 127); }

__device__ __forceinline__ void ln_rows(const float* R, const float* gam, const float* bet, float* hf, bf16_t* hb, int gw, int NGW, int lane) {
    f32x4 gv[4], bv[4];
#pragma unroll
    for (int j = 0; j < 4; ++j) { gv[j] = ((const f32x4*)gam)[lane + 64 * j]; bv[j] = ((const f32x4*)bet)[lane + 64 * j]; }
    for (int m = gw; m < M; m += NGW) {
        const f32x4* xr = (const f32x4*)(R + (size_t)m * D) + lane;
        f32x4 v[4]; float s = 0.f;
#pragma unroll
        for (int j = 0; j < 4; ++j) { v[j] = xr[64 * j]; s += (v[j].x + v[j].y) + (v[j].z + v[j].w); }
        const float mean = wave_sum(s) * (1.f / D); float s2 = 0.f;
#pragma unroll
        for (int j = 0; j < 4; ++j) { v[j] = v[j] - mean; s2 += (v[j].x * v[j].x + v[j].y * v[j].y) + (v[j].z * v[j].z + v[j].w * v[j].w); }
        const float rstd = 1.f / sqrtf(wave_sum(s2) * (1.f / D) + LN_EPS);
#pragma unroll
        for (int j = 0; j < 4; ++j) { const f32x4 o = v[j] * rstd * gv[j] + bv[j];
            ((f32x4*)(hf + (size_t)m * D))[lane + 64 * j] = o;
            if (hb) { u32x2 w; w.x = pk2(o.x, o.y); w.y = pk2(o.z, o.w); ((u32x2*)(hb + (size_t)m * D))[lane + 64 * j] = w; } }
    }
}

constexpr int QKP = 2048;
constexpr int AT_KP = 72;
constexpr int AT_KS = 0, AT_VS = 64 * AT_KP * 2, AT_FLAG = 2 * 64 * AT_KP * 2;
__device__ __forceinline__ void attn_unit(LAS unsigned char* lds, int b, int h, int qb, const bf16_t* Q, const bf16_t* Kg, const bf16_t* Vt, bf16_t* O) {
    int tid = threadIdx.x; asm volatile("" : "+v"(tid));
    const int lane = tid & 63, r32 = lane & 31, hi = lane >> 5; const int wid = __builtin_amdgcn_readfirstlane(tid >> 6);
    const int q0 = qb * 256, tq = q0 + 32 * wid + r32;
    LAS bf16_t* Ks = (LAS bf16_t*)(lds + AT_KS); LAS bf16_t* Vs = (LAS bf16_t*)(lds + AT_VS); volatile LAS unsigned* flag = (volatile LAS unsigned*)(lds + AT_FLAG);
    const size_t rowb = (size_t)b * SEQ;
    bf16x8 qf[4];
    { const bf16_t* Qw = Q + (rowb + tq) * QKP + h * HD;
#pragma unroll
      for (int ks = 0; ks < 4; ++ks) qf[ks] = *(const bf16x8*)(Qw + 16 * ks + 8 * hi); }
    f32x16 o0, o1;
#pragma unroll
    for (int r = 0; r < 16; ++r) { o0[r] = 0.f; o1[r] = 0.f; }
    float carry = 0.f; bool wdone = false, counted = false;
    const int wave_last = (q0 + 32 * wid + 31) >> 6;
    const int srow = tid >> 3, sch = tid & 7;
    const bf16_t* ksrc = Kg + (rowb + srow) * QKP + h * HD + 8 * sch;
    const bf16_t* vsrc = Vt + (size_t)(h * HD + srow) * M + rowb + 8 * sch;
    int jt = 4 * qb + 3;
    u32x4 kreg = *(const u32x4*)(ksrc + (size_t)(64 * jt) * QKP), vreg = *(const u32x4*)(vsrc + 64 * jt);
    __syncthreads();
    if (tid == 0) flag[0] = 0u;
    for (; jt >= 0; --jt) {
        __syncthreads();
        if (flag[0] >= 8u) break;
        *(LAS u32x4*)(Ks + srow * AT_KP + 8 * sch) = kreg; *(LAS u32x4*)(Vs + srow * AT_KP + 8 * sch) = vreg;
        __syncthreads();
        if (jt > 0) { kreg = *(const u32x4*)(ksrc + (size_t)(64 * (jt - 1)) * QKP); vreg = *(const u32x4*)(vsrc + 64 * (jt - 1)); }
        if (jt <= wave_last && !wdone) {
            f32x16 p0, p1;
#pragma unroll
            for (int r = 0; r < 16; ++r) { p0[r] = 0.f; p1[r] = 0.f; }
#pragma unroll
            for (int ks = 0; ks < 4; ++ks) {
                const bf16x8 k0 = *(const LAS bf16x8*)(Ks + r32 * AT_KP + 16 * ks + 8 * hi), k1 = *(const LAS bf16x8*)(Ks + (32 + r32) * AT_KP + 16 * ks + 8 * hi);
                p0 = __builtin_amdgcn_mfma_f32_32x32x16_bf16(k0, qf[ks], p0, 0, 0, 0); p1 = __builtin_amdgcn_mfma_f32_32x32x16_bf16(k1, qf[ks], p1, 0, 0, 0);
            }
            const bool need_mask = (64 * jt + 63 >= q0 + 32 * wid);
            const int sb = 64 * jt + 4 * hi;
            float sp[32], zz[32];
#pragma unroll
            for (int r = 0; r < 32; ++r) { const float z = (r < 16) ? p0[r & 15] : p1[r & 15]; zz[r] = z;
                const float e = __builtin_amdgcn_exp2f(-__builtin_fabsf(z)); const float l = __builtin_amdgcn_logf(1.0f + e); float s = __builtin_fmaxf(z, 0.f) + l;
                if (need_mask) { const int key = sb + ((r & 3) + 8 * ((r & 15) >> 2) + (r >> 4) * 32); if (key >= tq) s = 0.f; }
                sp[r] = s; }
            float gs[8], oth[8], Rr[8];
#pragma unroll
            for (int c = 0; c < 8; ++c) { gs[c] = (sp[4 * c] + sp[4 * c + 1]) + (sp[4 * c + 2] + sp[4 * c + 3]); oth[c] = __shfl_xor(gs[c], 32); }
            float run = 0.f;
#pragma unroll
            for (int c = 7; c >= 0; --c) { Rr[c] = run; run += gs[c] + oth[c]; }
            float wv[32];
#pragma unroll
            for (int c = 0; c < 8; ++c) { const float base = carry + Rr[c] + (hi == 0 ? oth[c] : 0.f);
                const float e3 = base, e2 = e3 + sp[4 * c + 3], e1 = e2 + sp[4 * c + 2], e0 = e1 + sp[4 * c + 1];
                wv[4 * c + 3] = __builtin_amdgcn_exp2f(zz[4 * c + 3] - sp[4 * c + 3] - e3); wv[4 * c + 2] = __builtin_amdgcn_exp2f(zz[4 * c + 2] - sp[4 * c + 2] - e2);
                wv[4 * c + 1] = __builtin_amdgcn_exp2f(zz[4 * c + 1] - sp[4 * c + 1] - e1); wv[4 * c + 0] = __builtin_amdgcn_exp2f(zz[4 * c + 0] - sp[4 * c + 0] - e0); }
            if (need_mask) {
#pragma unroll
                for (int r = 0; r < 32; ++r) { const int key = sb + ((r & 3) + 8 * ((r & 15) >> 2) + (r >> 4) * 32); if (key >= tq) wv[r] = 0.f; }
            }
            carry += run;
            u32x4 pa[4];
#pragma unroll
            for (int kk = 0; kk < 4; ++kk) { pa[kk].x = cvt_pk_bf16(wv[8 * kk + 0], wv[8 * kk + 1]); pa[kk].y = cvt_pk_bf16(wv[8 * kk + 2], wv[8 * kk + 3]); pa[kk].z = cvt_pk_bf16(wv[8 * kk + 4], wv[8 * kk + 5]); pa[kk].w = cvt_pk_bf16(wv[8 * kk + 6], wv[8 * kk + 7]); }
#pragma unroll
            for (int kk = 0; kk < 4; ++kk) { const int koff = (kk >> 1) * 32 + (kk & 1) * 16 + 4 * hi;
                const s16x4 a0 = *(const LAS s16x4*)(Vs + r32 * AT_KP + koff), a1 = *(const LAS s16x4*)(Vs + r32 * AT_KP + koff + 8);
                const s16x4 c0 = *(const LAS s16x4*)(Vs + (32 + r32) * AT_KP + koff), c1 = *(const LAS s16x4*)(Vs + (32 + r32) * AT_KP + koff + 8);
                const bf16x8 v0 = (bf16x8){a0[0], a0[1], a0[2], a0[3], a1[0], a1[1], a1[2], a1[3]}, v1 = (bf16x8){c0[0], c0[1], c0[2], c0[3], c1[0], c1[1], c1[2], c1[3]};
                const bf16x8 pf = __builtin_bit_cast(bf16x8, pa[kk]);
                o0 = __builtin_amdgcn_mfma_f32_32x32x16_bf16(pf, v0, o0, 0, 0, 0); o1 = __builtin_amdgcn_mfma_f32_32x32x16_bf16(pf, v1, o1, 0, 0, 0); }
            if (__all(carry > DONE_THR)) wdone = true;
        }
        if (wdone && !counted) { counted = true; if (lane == 0) __hip_atomic_fetch_add((LAS unsigned*)(lds + AT_FLAG), 1u, __ATOMIC_RELAXED, __HIP_MEMORY_SCOPE_WORKGROUP); }
    }
    bf16_t* Ow = O + (rowb + q0 + 32 * wid) * D + h * HD;
#pragma unroll
    for (int r = 0; r < 16; ++r) { const int qr = (r & 3) + 8 * (r >> 2) + 4 * hi;
        Ow[(size_t)qr * D + r32] = (bf16_t)f2bf(o0[r]); Ow[(size_t)qr * D + 32 + r32] = (bf16_t)f2bf(o1[r]); }
}

struct Args { const float* in[19]; float* out; unsigned char* ws; };
__global__ void __launch_bounds__(512, 2) fwd_kernel(Args a) {
    extern __shared__ __attribute__((aligned(16))) unsigned char lds_raw[];
    LAS unsigned char* lds = (LAS unsigned char*)lds_raw;
    cg::grid_group grid = cg::this_grid();
    const int G = gridDim.x, bx = blockIdx.x, NGW = G * 8, GT = G * 512;
#define TIDS() int tid = threadIdx.x; asm volatile("" : "+v"(tid)); const int lane = tid & 63, wave = __builtin_amdgcn_readfirstlane(tid >> 6), gw = bx * 8 + wave, gtid = bx * 512 + tid; (void)lane; (void)gw; (void)gtid
    unsigned char* ws = a.ws;
    const float* x = a.in[0];
    bf16_t* Wglu_t = (bf16_t*)(ws + WS_WGLU); bf16_t* Wout_t = (bf16_t*)(ws + WS_WOUT); bf16_t* Wqkv_t = (bf16_t*)(ws + WS_WQKV); bf16_t* Wo_t = (bf16_t*)(ws + WS_WO);
    bf16_t* Wgu0 = (bf16_t*)(ws + WS_WGU0); bf16_t* Wgu1 = (bf16_t*)(ws + WS_WGU1); bf16_t* Wdn0 = (bf16_t*)(ws + WS_WDN0); bf16_t* Wdn1 = (bf16_t*)(ws + WS_WDN1);
    f32x2* apow = (f32x2*)(ws + WS_APOW); f32x2* bbar = (f32x2*)(ws + WS_BBAR); float* Kc = (float*)(ws + WS_KC);
    bf16_t* xg = (bf16_t*)(ws + WS_XG); bf16_t* Bssm = (bf16_t*)(ws + WS_BSSM); bf16_t* Bst = (bf16_t*)(ws + WS_BST); float* Sloc = (float*)(ws + WS_SLOC);
    bf16_t* hb = (bf16_t*)(ws + WS_HB); bf16_t* zb = (bf16_t*)(ws + WS_Z); float* hf = (float*)(ws + WS_HF); bf16_t* hbf = (bf16_t*)(ws + WS_HBF); bf16_t* hid = (bf16_t*)(ws + WS_HID);
    bf16_t* Qb = (bf16_t*)(ws + WS_Q); bf16_t* Vt = (bf16_t*)(ws + WS_VT); bf16_t* ob = (bf16_t*)(ws + WS_OB);
    float* Rb = a.out;

    {
        TIDS();
        LAS float* scr = (LAS float*)(lds + wave * 16384);
        constexpr int I_GLU = 16 * 64, I_OUT = 16 * 32, I_QKV = 16 * 96, I_O = 16 * 32, I_GU = 16 * 176, I_DN = 44 * 32;
        constexpr int NIT = I_GLU + I_OUT + I_QKV + I_O + 2 * I_GU + 2 * I_DN;
        for (int it = gw; it < NIT; it += NGW) {
            int r = it;
            if (r < I_GLU) { const int kb = r / 64, n0 = 32 * (r % 64); transpose_item(a.in[9], 1024, 2048, Wglu_t, 64 * kb, n0, paired_row(n0, 1024), scr, lane); continue; } r -= I_GLU;
            if (r < I_OUT) { const int kb = r / 32, n0 = 32 * (r % 32); transpose_item(a.in[10], 1024, 1024, Wout_t, 64 * kb, n0, n0, scr, lane); continue; } r -= I_OUT;
            if (r < I_QKV) { const int kb = r / 96, n0 = 32 * (r % 96); transpose_item(a.in[11], 1024, 3072, Wqkv_t, 64 * kb, n0, n0, scr, lane); continue; } r -= I_QKV;
            if (r < I_O) { const int kb = r / 32, n0 = 32 * (r % 32); transpose_item(a.in[12], 1024, 1024, Wo_t, 64 * kb, n0, n0, scr, lane); continue; } r -= I_O;
            if (r < 2 * I_GU) { const int l = r / I_GU; r -= l * I_GU; const int kb = r / 176, n0 = 32 * (r % 176); transpose_item(a.in[13] + (size_t)l * 1024 * 5632, 1024, 5632, l ? Wgu1 : Wgu0, 64 * kb, n0, paired_row(n0, FF), scr, lane); continue; } r -= 2 * I_GU;
            { const int l = r / I_DN; r -= l * I_DN; const int kb = r / 32, n0 = 32 * (r % 32); transpose_item(a.in[14] + (size_t)l * FF * 1024, FF, 1024, l ? Wdn1 : Wdn0, 64 * kb, n0, n0, scr, lane); }
        }
        for (int it = bx; it < GROWS * 8; it += G) { const int rc = it >> 3, g = (it & 7) * 8 + wave;
#pragma unroll
            for (int i4 = 0; i4 < 4; ++i4) { const int j = 16 * i4 + (lane >> 2), h4 = 4 * (lane & 3);
                const f32x4 v = *(const f32x4*)(x + (size_t)(rc * CH + j) * D + 16 * g + h4);
                u32x2 w; w.x = pk2(v.x, v.y); w.y = pk2(v.z, v.w);
                *(u32x2*)(xg + (size_t)(g * GROWS + rc) * KA + 128 + 16 * j + h4) = w; } }
        const float* a_re = a.in[1]; const float* a_im = a.in[2]; const float* log_dt = a.in[3]; const float* b_re = a.in[4]; const float* b_im = a.in[5];
        for (int idx = gtid; idx < NG * 65 * NP; idx += GT) { const int g = idx / (65 * NP), rem = idx % (65 * NP), d = rem >> 6, p = rem & 63;
            const double dt = exp((double)log_dt[g]), lre = (double)fminf(a_re[g * NP + p], -1e-4f), lim = (double)a_im[g * NP + p];
            const double mag = exp(lre * dt * (double)d); double s, c; dsincos(lim * dt * (double)d, s, c);
            apow[idx] = (f32x2){(float)(mag * c), (float)(mag * s)}; }
        for (int idx = gtid; idx < NG * NP; idx += GT) { const int g = idx >> 6;
            const double dt = exp((double)log_dt[g]), lre = (double)fminf(a_re[idx], -1e-4f), lim = (double)a_im[idx];
            const double mag = exp(lre * dt); double s, c; dsincos(lim * dt, s, c);
            const double nr = mag * c - 1.0, ni = mag * s, den = lre * lre + lim * lim;
            const double cr = (nr * lre + ni * lim) / den, ci = (ni * lre - nr * lim) / den;
#pragma unroll 4
            for (int h = 0; h < GH; ++h) { const double br = (double)b_re[idx * GH + h], bi = (double)b_im[idx * GH + h];
                bbar[idx * GH + h] = (f32x2){(float)(cr * br - ci * bi), (float)(cr * bi + ci * br)}; } }
    }
    grid.sync();
    {
        TIDS();
        const float* c_re = a.in[6]; const float* c_im = a.in[7];
        LAS f32x2* Cs = (LAS f32x2*)lds; LAS f32x2* Bs = (LAS f32x2*)(lds + 8192); LAS f32x2* As = (LAS f32x2*)(lds + 16384);
        for (int it = bx; it < NG * 4; it += G) { const int g = it >> 2, dq = it & 3;
            __syncthreads();
            for (int e = tid; e < 1024; e += 512) { Cs[e] = (f32x2){c_re[g * 1024 + e], c_im[g * 1024 + e]}; Bs[e] = bbar[g * 1024 + e]; As[e] = apow[(g * 65 + 16 * dq) * NP + e]; }
            __syncthreads();
#pragma unroll 1
            for (int k = 0; k < 8; ++k) { const int idx = tid + 512 * k, dl = idx >> 8, h = (idx >> 4) & 15, hp = idx & 15; float acc = 0.f;
#pragma unroll 8
                for (int p = 0; p < NP; ++p) { const f32x2 c = Cs[h * 64 + p], aa = As[dl * 64 + p], bb = Bs[p * 16 + hp];
                    const float gr = c.x * aa.x - c.y * aa.y, gi = c.x * aa.y + c.y * aa.x; acc += gr * bb.x - gi * bb.y; }
                Kc[((size_t)(g * 64 + 16 * dq + dl) * 16 + h) * 16 + hp] = acc; }
        }
        for (int idx = gtid; idx < NG * 1024 * 16; idx += GT) { const int g = idx >> 14, n = (idx >> 4) & 1023, k0 = 8 * (idx & 15), i = n >> 4, h = n & 15;
            float v[8];
#pragma unroll
            for (int e = 0; e < 8; ++e) { const int k = k0 + e, p = k & 63; const float cr = c_re[(g * 16 + h) * 64 + p], ci = c_im[(g * 16 + h) * 64 + p]; const f32x2 aa = apow[(g * 65 + i + 1) * NP + p];
                v[e] = (k < 64) ? (cr * aa.x - ci * aa.y) : -(cr * aa.y + ci * aa.x); }
            u32x4 w; w.x = pk2(v[0], v[1]); w.y = pk2(v[2], v[3]); w.z = pk2(v[4], v[5]); w.w = pk2(v[6], v[7]);
            *(u32x4*)(Bssm + (size_t)(g * 1024 + n) * KA + k0) = w; }
        for (int idx = gtid; idx < NG * 256 * 128; idx += GT) { const int g = idx >> 15, n = (idx >> 7) & 255, k0 = 8 * (idx & 127), j = k0 >> 4, h0 = k0 & 15;
            u32x4 w = (u32x4){0u, 0u, 0u, 0u};
            if (n < 128) { const int p = n & 63; const f32x2 aa = apow[(g * 65 + 63 - j) * NP + p]; float v[8];
#pragma unroll
                for (int e = 0; e < 8; ++e) { const f32x2 bb = bbar[(g * 64 + p) * 16 + h0 + e]; v[e] = (n < 64) ? (aa.x * bb.x - aa.y * bb.y) : (aa.x * bb.y + aa.y * bb.x); }
                w.x = pk2(v[0], v[1]); w.y = pk2(v[2], v[3]); w.z = pk2(v[4], v[5]); w.w = pk2(v[6], v[7]); }
            *(u32x4*)(Bst + (size_t)(g * 256 + n) * 1024 + k0) = w; }
    }
    grid.sync();
    { TIDS();
    for (int idx = gtid; idx < NG * 1024 * 128; idx += GT) { const int g = idx >> 17, n = (idx >> 7) & 1023, pc = idx & 127, j = pc >> 1, h0 = 8 * (pc & 1), i = n >> 4, h = n & 15;
        u32x4 w = (u32x4){0u, 0u, 0u, 0u};
        if (j <= i) { const float* kp = Kc + ((size_t)(g * 64 + (i - j)) * 16 + h) * 16 + h0; const f32x4 k0 = *(const f32x4*)kp, k1 = *(const f32x4*)(kp + 4);
            w.x = pk2(k0.x, k0.y); w.y = pk2(k0.z, k0.w); w.z = pk2(k1.x, k1.y); w.w = pk2(k1.z, k1.w); }
        *(u32x4*)(Bssm + (size_t)(g * 1024 + n) * KA + 128 + 8 * pc) = w; } }
    grid.sync();
    { pg8::Gemm g{xg + 128, Bst, KA, 1024, 1024}; pg8::GroupOrderS S{G, bx}; pg8::EpiState E{Sloc};
      pg8::gemm_phase<pg8::EpiState, pg8::GroupOrderS, false>(lds, g, S, E); }
    grid.sync();
    { TIDS();
    for (int g = bx; g < NG; g += G) { const int b = tid >> 6, p = tid & 63; const f32x2 a64 = apow[(g * 65 + 64) * NP + p]; float sr = 0.f, si = 0.f;
#pragma unroll 4
        for (int c = 0; c < NCH; ++c) { const size_t row = (size_t)g * GROWS + b * NCH + c;
            xg[row * KA + p] = (bf16_t)f2bf(sr); xg[row * KA + 64 + p] = (bf16_t)f2bf(si);
            const float lr = Sloc[row * 128 + p], li = Sloc[row * 128 + 64 + p];
            const float nr = a64.x * sr - a64.y * si + lr, ni = a64.x * si + a64.y * sr + li; sr = nr; si = ni; } } }
    grid.sync();
    { pg8::Gemm g{xg, Bssm, KA, KA, KA}; pg8::GroupOrderY S{G, bx}; pg8::EpiY E{x, a.in[8], hb};
      pg8::gemm_phase<pg8::EpiY, pg8::GroupOrderY, true>(lds, g, S, E); }
    grid.sync();
    { pg8::Gemm g{hb, Wglu_t, 1024, 1024, 1024}; pg8::StaticOrder S; S.init(M, 2048, G, bx); pg8::EpiPair<0> E{zb, 1024};
      pg8::gemm_phase<pg8::EpiPair<0>, pg8::StaticOrder, true>(lds, g, S, E); }
    grid.sync();
#pragma unroll 1
    for (int layer = 0; layer < 2; ++layer) {
        if (layer == 1) {
            { pg8::Gemm g{hbf, Wqkv_t, 1024, 1024, 1024}; pg8::StaticOrder S; S.init(M, 2048, G, bx); pg8::EpiBf16 E{Qb, 2048, 4, QSCALE};
              pg8::gemm_phase<pg8::EpiBf16, pg8::StaticOrder, true>(lds, g, S, E); }
            { pg8::Gemm g{Wqkv_t + (size_t)2048 * 1024, hbf, 1024, 1024, 1024}; pg8::StaticOrder S; S.init(1024, M, G, bx); pg8::EpiBf16 E{Vt, M, 0, 1.f};
              pg8::gemm_phase<pg8::EpiBf16, pg8::StaticOrder, true>(lds, g, S, E); }
            grid.sync();
            for (int it = bx; it < 256; it += G) { const int bh = it >> 1, s = it & 1;
#pragma unroll 1
                for (int i = 7; i >= 0; --i) { const int qb = s ? ((i & 1) ? 2 * i : 2 * i + 1) : ((i & 1) ? 2 * i + 1 : 2 * i);
                    attn_unit(lds, bh >> 4, bh & 15, qb, Qb, Qb + 1024, Vt, ob); } }
            __syncthreads();
            grid.sync();
        }
        { pg8::Gemm g{layer == 0 ? zb : ob, layer == 0 ? Wout_t : Wo_t, 1024, 1024, 1024}; pg8::StaticOrder S; S.init(M, 1024, G, bx); pg8::EpiRes E{layer == 0 ? x : hf, Rb, ALPHA};
          pg8::gemm_phase<pg8::EpiRes, pg8::StaticOrder, true>(lds, g, S, E); }
        grid.sync();
        { TIDS(); ln_rows(Rb, a.in[15] + layer * D, a.in[16] + layer * D, hf, hbf, gw, NGW, lane); }
        grid.sync();
        { pg8::Gemm g{hbf, layer ? Wgu1 : Wgu0, 1024, 1024, 1024}; pg8::StaticOrder S; S.init(M, 2 * FF, G, bx); pg8::EpiPair<1> E{hid, FF};
          pg8::gemm_phase<pg8::EpiPair<1>, pg8::StaticOrder, true>(lds, g, S, E); }
        grid.sync();
        { pg8::Gemm g{hid, layer ? Wdn1 : Wdn0, FF, FF, FF}; pg8::StaticOrder S; S.init(M, 1024, G, bx); pg8::EpiRes E{hf, Rb, ALPHA};
          pg8::gemm_phase<pg8::EpiRes, pg8::StaticOrder, true>(lds, g, S, E); }
        grid.sync();
        { TIDS(); ln_rows(Rb, a.in[17] + layer * D, a.in[18] + layer * D, layer == 1 ? Rb : hf, layer == 1 ? (bf16_t*)nullptr : hbf, gw, NGW, lane); }
        if (layer == 0) grid.sync();
    }
}

extern "C" void kernel_launch(void* const* d_in, const int* in_sizes, int n_in, void* d_out, int out_size, void* d_ws, size_t ws_size, hipStream_t stream) {
    static int grid = 0;
    if (grid == 0) {
        if (n_in != 19 || in_sizes[0] != M * D || out_size != M * D || ws_size < WS_END) { fprintf(stderr, "kernel_launch: unexpected shapes (n_in %d, in0 %d, out %d, ws %zu)\n", n_in, n_in > 0 ? in_sizes[0] : -1, out_size, ws_size); grid = -1; return; }
        int dev = 0, cus = 0, per_cu = 0;
        (void)hipGetDevice(&dev); (void)hipDeviceGetAttribute(&cus, hipDeviceAttributeMultiprocessorCount, dev);
        if (hipFuncSetAttribute((const void*)fwd_kernel, hipFuncAttributeMaxDynamicSharedMemorySize, LDS_BYTES) != hipSuccess) { fprintf(stderr, "kernel_launch: hipFuncSetAttribute failed\n"); grid = -1; return; }
        if (hipOccupancyMaxActiveBlocksPerMultiprocessor(&per_cu, (const void*)fwd_kernel, 512, LDS_BYTES) != hipSuccess || per_cu < 1) { fprintf(stderr, "kernel_launch: occupancy query says %d blocks per CU\n", per_cu); per_cu = 1; }
        (void)hipGetLastError();
        grid = cus;
    }
    if (grid < 0) return;
    Args a{};
    for (int i = 0; i < 19; ++i) a.in[i] = (const float*)d_in[i];
    a.out = (float*)d_out; a.ws = (unsigned char*)d_ws;
    void* args[] = {&a};
    hipError_t e = hipLaunchCooperativeKernel((const void*)fwd_kernel, dim3(grid), dim3(512), args, LDS_BYTES, stream);
    if (e != hipSuccess) fprintf(stderr, "kernel_launch: cooperative launch failed: %s (grid %d)\n", hipGetErrorString(e), grid);
}
```
